# Optimizing an MI355X kernel written in HIP

```python
import math, functools
import jax, jax.numpy as jnp
from jax import lax
import numpy as np

D_MODEL = 1024
BATCH = 16
SEQ = 256
DEPTH = 2
DEC_BATCH = 8
DEC_SEQ = 4096
PAST_LEN = 256

GRID_W = 64
N_MIXERS = 2
N_LRU_LAYERS = (DEPTH + 1) // 2
N_S5_LAYERS = DEPTH // 2
N_DIR = 2
D_RNN = D_MODEL
LRU_HEADS = 16
LRU_BLOCK = D_RNN // LRU_HEADS
LRU_C = 8.0
LRU_CONV = 4
S5_GROUP = 16
S5_GROUPS = D_MODEL // S5_GROUP
S5_STATE = 64
D_FF = 2816
FFN_CONV = 3
N_MOD = 6
EPS = 1e-6

kernel_name = "hybrid_rglru_s5_diffusion_step"

F32 = jnp.float32


def rms_norm(x, g):
    x32 = x.astype(F32)
    y = x32 * lax.rsqrt(jnp.mean(x32 * x32, axis=-1, keepdims=True) + EPS)
    return (y * g.astype(F32)).astype(x.dtype)


def modulate(x, g, shift, scale):
    return rms_norm(x, g) * (1 + scale) + shift


def depthwise_conv_seq(x, w, b, pad_left, pad_right):
    L = x.shape[1]
    xp = jnp.pad(x, ((0, 0), (pad_left, pad_right), (0, 0)))
    y = b
    for k in range(w.shape[0]):
        y = y + xp[:, k:k + L] * w[k]
    return y


def _combine(e1, e2):
    a1, b1 = e1
    a2, b2 = e2
    return a1 * a2, a2 * b1 + b2


def linear_scan(a, b, h0, reverse):
    edge = -1 if reverse else 0
    b = b.at[:, edge].add(a[:, edge] * h0)
    _, h = lax.associative_scan(_combine, (a, b), reverse=reverse, axis=1)
    return h, (h[:, 0] if reverse else h[:, -1])


def rglru_mixer(h, h0, w_in, conv_w, conv_b, w_a, b_a, w_i, b_i, lam, w_out):
    B, L, _ = h.shape
    gate, xr = jnp.split(h @ w_in, 2, axis=-1)
    xr = depthwise_conv_seq(xr, conv_w, conv_b, 2, 1).astype(F32)
    xb = xr.reshape(B, L, LRU_HEADS, LRU_BLOCK)
    y = 0.0
    finals = []
    for d in range(N_DIR):
        r = jax.nn.sigmoid(jnp.einsum('blhi,hij->blhj', xb, w_a[d].astype(F32)).reshape(B, L, D_RNN) + b_a[d].astype(F32))
        i = jax.nn.sigmoid(jnp.einsum('blhi,hij->blhj', xb, w_i[d].astype(F32)).reshape(B, L, D_RNN) + b_i[d].astype(F32))
        log_a = -LRU_C * r * jax.nn.softplus(-lam[d].astype(F32))
        a = jnp.exp(log_a)
        bx = jnp.sqrt(-jnp.expm1(2.0 * log_a)) * (i * xr)
        hs, hf = linear_scan(a, bx, h0[:, d], reverse=(d == 1))
        y = y + hs
        finals.append(hf)
    out = (y * jax.nn.gelu(gate.astype(F32))).astype(h.dtype) @ w_out
    return out, jnp.stack(finals, axis=1)


def s5_mixer(h, h0, a_re, a_im, log_dt, b_re, b_im, c_re, c_im, d_skip, w_glu):
    B, L, _ = h.shape
    u = h.astype(F32).reshape(B, L, S5_GROUPS, S5_GROUP)
    uc = u.astype(jnp.complex64)
    y = d_skip.astype(F32).reshape(S5_GROUPS, S5_GROUP) * u
    finals = []
    for d in range(N_DIR):
        lam = lax.complex(a_re[d].astype(F32), a_im[d].astype(F32))
        dt = jnp.exp(log_dt[d].astype(F32))[:, None]
        a_bar = jnp.exp(lam * dt)
        b_bar = lax.complex(b_re[d].astype(F32), b_im[d].astype(F32)) * ((a_bar - 1.0) / lam)[..., None]
        bu = jnp.einsum('blgc,gpc->blgp', uc, b_bar)
        a_seq = jnp.broadcast_to(a_bar, (1, L) + a_bar.shape)
        hs, hf = linear_scan(a_seq, bu, h0[:, d], reverse=(d == 1))
        cc = lax.complex(c_re[d].astype(F32), c_im[d].astype(F32))
        y = y + jnp.real(jnp.einsum('blgp,gcp->blgc', hs, cc))
        finals.append(hf)
    z = jax.nn.gelu(y.reshape(B, L, D_MODEL)).astype(h.dtype)
    v, g = jnp.split(z @ w_glu, 2, axis=-1)
    return v * jax.nn.sigmoid(g), jnp.stack(finals, axis=1)


def conv_ffn(h, on_grid, w_up, conv_w, conv_b, w_down):
    B, L, _ = h.shape
    up = h @ w_up
    if on_grid:
        rows = L // GRID_W
        up = depthwise_conv_seq(up.reshape(B * rows, GRID_W, 2 * D_FF), conv_w, conv_b, 1, 1).reshape(B, L, 2 * D_FF)
    else:
        up = depthwise_conv_seq(up, conv_w, conv_b, 1, 1)
    v, g = jnp.split(up, 2, axis=-1)
    return (v * jax.nn.silu(g)) @ w_down


def apply_layer(x, mod, h0, on_grid, mixer, g_mix, g_ffn, w_up, conv_w, conv_b, w_down):
    sh1, sc1, gt1, sh2, sc2, gt2 = jnp.split(mod, N_MOD, axis=-1)
    out, final = mixer(modulate(x, g_mix, sh1, sc1), h0)
    x = x + gt1 * out
    x = x + gt2 * conv_ffn(modulate(x, g_ffn, sh2, sc2), on_grid, w_up, conv_w, conv_b, w_down)
    return x, final


def setup_inputs(seed: int = 0) -> dict:
    key = jax.random.key(seed)
    ks = iter(jax.random.split(key, 40))

    def nrm(shape, scale):
        return jax.random.normal(next(ks), shape, F32) * scale

    u = jax.random.uniform(next(ks), (N_LRU_LAYERS, N_DIR, D_RNN), F32, minval=0.9, maxval=0.999)
    lru_lambda = jnp.log(u) - jnp.log1p(-u)
    a_im = jnp.pi * jnp.arange(S5_STATE, dtype=F32)
    return {
        "x_prompt": nrm((BATCH, SEQ, D_MODEL), 1.0),
        "x_sample": nrm((DEC_BATCH, DEC_SEQ, D_MODEL), 1.0),
        "state_lru": nrm((DEC_BATCH, N_LRU_LAYERS, N_DIR, D_RNN), 0.5),
        "state_s5_re": nrm((DEC_BATCH, N_S5_LAYERS, N_DIR, S5_GROUPS, S5_STATE), 0.5),
        "state_s5_im": nrm((DEC_BATCH, N_S5_LAYERS, N_DIR, S5_GROUPS, S5_STATE), 0.5),
        "c": nrm((DEC_BATCH, D_MODEL), 1.0),
        "c_ctx": nrm((D_MODEL,), 1.0),
        "ada_w": nrm((DEPTH, D_MODEL, N_MOD * D_MODEL), 0.5 * D_MODEL ** -0.5),
        "ada_b": nrm((DEPTH, N_MOD * D_MODEL), 0.02),
        "norm_mix": 1.0 + nrm((DEPTH, D_MODEL), 0.02),
        "norm_ffn": 1.0 + nrm((DEPTH, D_MODEL), 0.02),
        "norm_final": 1.0 + nrm((D_MODEL,), 0.02),
        "lru_w_in": nrm((N_LRU_LAYERS, D_MODEL, 2 * D_RNN), D_MODEL ** -0.5),
        "lru_conv_w": nrm((N_LRU_LAYERS, LRU_CONV, D_RNN), 0.5),
        "lru_conv_b": nrm((N_LRU_LAYERS, D_RNN), 0.02),
        "lru_w_a": nrm((N_LRU_LAYERS, N_DIR, LRU_HEADS, LRU_BLOCK, LRU_BLOCK), LRU_BLOCK ** -0.5),
        "lru_b_a": nrm((N_LRU_LAYERS, N_DIR, D_RNN), 0.02),
        "lru_w_i": nrm((N_LRU_LAYERS, N_DIR, LRU_HEADS, LRU_BLOCK, LRU_BLOCK), LRU_BLOCK ** -0.5),
        "lru_b_i": nrm((N_LRU_LAYERS, N_DIR, D_RNN), 0.02),
        "lru_lambda": lru_lambda,
        "lru_w_out": nrm((N_LRU_LAYERS, D_RNN, D_MODEL), D_RNN ** -0.5),
        "s5_a_re": -0.5 + nrm((N_S5_LAYERS, N_DIR, S5_GROUPS, S5_STATE), 0.01),
        "s5_a_im": a_im + nrm((N_S5_LAYERS, N_DIR, S5_GROUPS, S5_STATE), 0.01),
        "s5_log_dt": jax.random.uniform(next(ks), (N_S5_LAYERS, N_DIR, S5_GROUPS), F32, minval=math.log(0.001), maxval=math.log(0.1)),
        "s5_b_re": nrm((N_S5_LAYERS, N_DIR, S5_GROUPS, S5_STATE, S5_GROUP), (2 * S5_GROUP) ** -0.5),
        "s5_b_im": nrm((N_S5_LAYERS, N_DIR, S5_GROUPS, S5_STATE, S5_GROUP), (2 * S5_GROUP) ** -0.5),
        "s5_c_re": nrm((N_S5_LAYERS, N_DIR, S5_GROUPS, S5_GROUP, S5_STATE), (2 * S5_STATE) ** -0.5),
        "s5_c_im": nrm((N_S5_LAYERS, N_DIR, S5_GROUPS, S5_GROUP, S5_STATE), (2 * S5_STATE) ** -0.5),
        "s5_d": nrm((N_S5_LAYERS, D_MODEL), 0.5),
        "s5_w_glu": nrm((N_S5_LAYERS, D_MODEL, 2 * D_MODEL), D_MODEL ** -0.5),
        "ffn_w_up": nrm((DEPTH, D_MODEL, 2 * D_FF), D_MODEL ** -0.5),
        "ffn_conv_w": nrm((DEPTH, FFN_CONV, 2 * D_FF), 0.5),
        "ffn_conv_b": nrm((DEPTH, 2 * D_FF), 0.02),
        "ffn_w_down": nrm((DEPTH, D_FF, D_MODEL), D_FF ** -0.5),
    }


def reference(x_prompt, x_sample, state_lru, state_s5_re, state_s5_im, c, c_ctx,
              ada_w, ada_b, norm_mix, norm_ffn, norm_final,
              lru_w_in, lru_conv_w, lru_conv_b, lru_w_a, lru_b_a, lru_w_i, lru_b_i, lru_lambda, lru_w_out,
              s5_a_re, s5_a_im, s5_log_dt, s5_b_re, s5_b_im, s5_c_re, s5_c_im, s5_d, s5_w_glu,
              ffn_w_up, ffn_conv_w, ffn_conv_b, ffn_w_down):
    x_p, x_s = x_prompt, x_sample
    bp = x_p.shape[0]
    new_lru, new_s5 = [], []
    for l in range(DEPTH):
        j = l // N_MIXERS
        mod_p = (jax.nn.silu(c_ctx) @ ada_w[l] + ada_b[l])[None, None, :]
        mod_s = (jax.nn.silu(c) @ ada_w[l] + ada_b[l])[:, None, :]
        if l % N_MIXERS == 0:
            mixer = functools.partial(rglru_mixer, w_in=lru_w_in[j], conv_w=lru_conv_w[j], conv_b=lru_conv_b[j],
                                      w_a=lru_w_a[j], b_a=lru_b_a[j], w_i=lru_w_i[j], b_i=lru_b_i[j],
                                      lam=lru_lambda[j], w_out=lru_w_out[j])
            h0_p = jnp.zeros((bp, N_DIR, D_RNN), F32)
            h0_s = state_lru[:, j].astype(F32)
        else:
            mixer = functools.partial(s5_mixer, a_re=s5_a_re[j], a_im=s5_a_im[j], log_dt=s5_log_dt[j],
                                      b_re=s5_b_re[j], b_im=s5_b_im[j], c_re=s5_c_re[j], c_im=s5_c_im[j],
                                      d_skip=s5_d[j], w_glu=s5_w_glu[j])
            h0_p = jnp.zeros((bp, N_DIR, S5_GROUPS, S5_STATE), jnp.complex64)
            h0_s = lax.complex(state_s5_re[:, j].astype(F32), state_s5_im[:, j].astype(F32))
        x_p, fin_p = apply_layer(x_p, mod_p, h0_p, False, mixer, norm_mix[l], norm_ffn[l],
                                 ffn_w_up[l], ffn_conv_w[l], ffn_conv_b[l], ffn_w_down[l])
        x_s, _ = apply_layer(x_s, mod_s, h0_s, True, mixer, norm_mix[l], norm_ffn[l],
                             ffn_w_up[l], ffn_conv_w[l], ffn_conv_b[l], ffn_w_down[l])
        if l % N_MIXERS == 0:
            new_lru.append(fin_p)
        else:
            new_s5.append(fin_p)
    y_prompt = rms_norm(x_p, norm_final)
    y_sample = rms_norm(x_s, norm_final)
    new_state_lru = jnp.stack(new_lru, axis=1)
    s5_state = jnp.stack(new_s5, axis=1)
    return (y_prompt, y_sample, new_state_lru, jnp.real(s5_state), jnp.imag(s5_state))
```

```cpp
#include <hip/hip_runtime.h>
#include <hip/hip_cooperative_groups.h>
#include <cstdio>
#include <cstdint>
namespace cg = cooperative_groups;

#define LAS __attribute__((address_space(3)))
typedef _Float16 h16;
typedef _Float16 h16x8 __attribute__((ext_vector_type(8)));
typedef _Float16 h16x2 __attribute__((ext_vector_type(2)));
typedef float f32x4 __attribute__((ext_vector_type(4)));
typedef float f32x16 __attribute__((ext_vector_type(16)));
typedef unsigned u32x4 __attribute__((ext_vector_type(4)));
typedef unsigned u32x2 __attribute__((ext_vector_type(2)));

constexpr int D = 1024, MP = 4096, M = 36864, DFF = 2816, NUP = 5632, NMR = 9, NMOD = 6144;
constexpr float EPS = 1e-6f;
constexpr int NCHK = M / 16;
constexpr size_t al256(size_t x) { return (x + 255) & ~(size_t)255; }
constexpr size_t O_MOD  = 0;
constexpr size_t O_SS   = O_MOD  + al256((size_t)2 * NMR * NMOD * 4);
constexpr size_t O_G1T  = O_SS   + al256((size_t)4 * M * 4);
constexpr size_t O_G2T  = O_G1T  + al256((size_t)2 * NMR * D * 4);
constexpr size_t O_SHW  = O_G2T  + al256((size_t)2 * NMR * D * 4);
constexpr size_t O_CWP  = O_SHW  + al256((size_t)2 * NMR * NUP * 4);
constexpr size_t O_CBP  = O_CWP  + al256((size_t)2 * 3 * NUP * 4);
constexpr size_t O_PW   = O_CBP  + al256((size_t)2 * NUP * 4);
constexpr size_t O_BBAR = O_PW   + al256((size_t)2 * 64 * 17 * 64 * 8);
constexpr size_t O_KT   = O_BBAR + al256((size_t)2 * 64 * 64 * 16 * 8);
constexpr size_t O_GF   = O_KT   + al256((size_t)64 * 2 * 16 * 256 * 4);
constexpr size_t O_WIN  = O_GF   + al256((size_t)524288);
constexpr size_t O_WOUT = O_WIN  + al256((size_t)2048 * 1024 * 2);
constexpr size_t O_WGLU = O_WOUT + al256((size_t)1024 * 1024 * 2);
constexpr size_t O_WUP  = O_WGLU + al256((size_t)2048 * 1024 * 2);
constexpr size_t O_WDN  = O_WUP  + al256((size_t)2 * NUP * 1024 * 2);
constexpr size_t O_WS   = O_WDN  + al256((size_t)2 * 1024 * DFF * 2);
constexpr size_t O_WY   = O_WS   + al256((size_t)64 * 256 * 256 * 2);
constexpr size_t O_HA   = O_WY   + al256((size_t)64 * 256 * 512 * 2);
constexpr size_t O_HB   = O_HA   + al256((size_t)M * D * 2);
constexpr size_t O_BIG  = O_HB   + al256((size_t)M * D * 2);
constexpr size_t O_GG   = O_BIG;
constexpr size_t O_XP   = O_BIG + (size_t)M * D * 2;
constexpr size_t O_SCR  = O_BIG + (size_t)2 * M * D * 2;
constexpr size_t O_ACT  = O_BIG;
constexpr size_t O_S    = O_BIG;
constexpr size_t O_H    = O_BIG + (size_t)64 * NCHK * 256 * 4;
constexpr size_t WS_END = O_BIG + (size_t)3 * M * D * 2;
static_assert((size_t)M * DFF * 2 <= (size_t)3 * M * D * 2, "act overlay");
static_assert((size_t)64 * NCHK * 256 * 6 <= (size_t)3 * M * D * 2, "S/H overlay");
constexpr size_t OUT_LRU = (size_t)M * D, OUT_S5RE = OUT_LRU + 32768, OUT_S5IM = OUT_S5RE + 131072;
constexpr int LDS_BYTES = 147456;
constexpr int EX_OFF = 131072;

struct Args { const float* in[34]; float* out; unsigned char* ws; int ph_lo, ph_hi; };
enum { I_XP = 0, I_XS, I_SLRU, I_S5RE, I_S5IM, I_C, I_CCTX, I_ADAW, I_ADAB, I_NMIX, I_NFFN, I_NFIN, I_WIN, I_LCW, I_LCB, I_WA, I_BA, I_WI, I_BI, I_LAM, I_WOUT,
       I_ARE, I_AIM, I_LDT, I_BRE, I_BIM, I_CRE, I_CIM, I_S5D, I_WGLU, I_WUP, I_FCW, I_FCB, I_WDN };

__device__ __forceinline__ unsigned pkh(float lo, float hi) { h16x2 v = {(h16)lo, (h16)hi}; return __builtin_bit_cast(unsigned, v); }
__device__ __forceinline__ float fsigmoid(float x) { return __builtin_amdgcn_rcpf(1.0f + __builtin_amdgcn_exp2f(-1.4426950409f * x)); }
__device__ __forceinline__ float fgelu(float x) {
    const float t = x * (1.0f + 0.044715f * x * x);
    return x * __builtin_amdgcn_rcpf(1.0f + __builtin_amdgcn_exp2f(-2.3022081985f * t));
}
__device__ __forceinline__ int mod_row(int pm) { return pm < 16 ? 0 : 1 + ((pm - 16) >> 4); }
template <int CTRL> __device__ __forceinline__ float dppf(float v) { return __builtin_bit_cast(float, __builtin_amdgcn_update_dpp(0, __builtin_bit_cast(int, v), CTRL, 0xf, 0xf, false)); }

constexpr int BM = 256, BK = 64, HALF = 128, HTB = HALF * BK * 2, NXCD = 8, WGM = 8;
__device__ __forceinline__ int lds_byte(int r, int c) { const int st = (r >> 4) * 2 + (c >> 5), rr = r & 15, cc = c & 31, ob = rr * 64 + cc * 2; return st * 1024 + (ob ^ (((ob >> 9) & 1) << 5)); }
__device__ __forceinline__ void stage_rc(int b, int& R, int& C) { const int st = b / 1024, sb = b % 1024, swz = sb ^ (((sb >> 9) & 1) << 5); R = (st >> 1) * 16 + swz / 64; C = (st & 1) * 32 + (swz % 64) / 2; }
__device__ __forceinline__ int perm32(int rho) { const int n = rho >> 4, i = rho & 15; return 8 * (i >> 2) + 4 * n + (i & 3); }
struct Unit { int pm, pn, g; };

struct ProbStd {
    const char* A; const char* Bt; int K, nM, nN, nwg, G, c;
    __device__ __forceinline__ void init(const void* A_, const void* Bt_, int Mr, int N, int K_, int G_, int c_) { A = (const char*)A_; Bt = (const char*)Bt_; K = K_; nM = Mr / BM; nN = N / BM; nwg = nM * nN; G = G_; c = c_; }
    __device__ __forceinline__ int nt() const { return K / BK; }
    __device__ __forceinline__ bool next(int i, Unit& u) const {
        const long L = (long)i * G + c; if (L >= nwg) return false;
        int wgid = (int)L; { const int q = nwg / NXCD, r = nwg % NXCD, xcd = wgid % NXCD, off = wgid / NXCD; wgid = (xcd < r ? xcd * (q + 1) : r * (q + 1) + (xcd - r) * q) + off; }
        const int nig = WGM * nN, gid = wgid / nig, fm = gid * WGM, gsz = (nM - fm) < WGM ? (nM - fm) : WGM;
        u.pm = fm + ((wgid % nig) % gsz); u.pn = (wgid % nig) / gsz; u.g = 0; return true;
    }
    __device__ __forceinline__ const char* aptr(const Unit& u, int kt, int h) const { return A + ((size_t)(u.pm * BM + h * HALF) * K + (size_t)kt * BK) * 2; }
    __device__ __forceinline__ const char* bptr(const Unit& u, int kt, int h) const { return Bt + ((size_t)(u.pn * BM + h * HALF) * K + (size_t)kt * BK) * 2; }
    __device__ __forceinline__ unsigned voffA(int R, int C, int) const { return (unsigned)(R * K + C) * 2u; }
    __device__ __forceinline__ unsigned voffB(int R, int C) const { return (unsigned)(R * K + C) * 2u; }
    __device__ __forceinline__ bool acls(int) const { return false; }
};
template <bool HASH> struct ProbS5 {
    const char* U; const char* Hh; const char* W; int Kw, G, c;
    __device__ __forceinline__ void init(const void* U_, const void* H_, const void* W_, int Kw_, int G_, int c_) { U = (const char*)U_; Hh = (const char*)H_; W = (const char*)W_; Kw = Kw_; G = G_; c = c_; }
    __device__ __forceinline__ int nt() const { return Kw / BK; }
    __device__ __forceinline__ bool next(int i, Unit& u) const { const long L = (long)i * G + c; if (L >= 576) return false; u.g = (int)(L / 9); u.pm = (int)(L % 9); u.pn = 0; return true; }
    __device__ __forceinline__ const char* aptr(const Unit& u, int kt, int h) const {
        const char* b = (HASH && kt >= 4) ? Hh : U; const int k4 = (HASH && kt >= 4) ? kt - 4 : kt;
        return b + (((size_t)(u.pm * BM + h * HALF) * 16 + (size_t)k4 * 4) * 1024 + (size_t)16 * u.g) * 2;
    }
    __device__ __forceinline__ const char* bptr(const Unit& u, int kt, int h) const { return W + ((size_t)u.g * 256 * Kw + (size_t)h * HALF * Kw + (size_t)kt * BK) * 2; }
    __device__ __forceinline__ unsigned voffA(int R, int C, int) const { return (unsigned)(R * 16384 + (C >> 4) * 1024 + (C & 15)) * 2u; }
    __device__ __forceinline__ unsigned voffB(int R, int C) const { return (unsigned)(R * Kw + C) * 2u; }
    __device__ __forceinline__ bool acls(int) const { return false; }
};

template <class Epi, class Prob, bool TWO_A>
__device__ __forceinline__ void gemm_phase(LAS unsigned char* lds, const Prob& P, const Epi& E) {
    const int tid = threadIdx.x, wid = __builtin_amdgcn_readfirstlane(tid >> 6), lane = tid & 63, wr = wid >> 2, wc = wid & 3, fr = lane & 15, fq = lane >> 4;
    const int nt = P.nt();
    unsigned voffA[2], voffA1[2], voffB[2];
#pragma unroll
    for (int i = 0; i < 2; ++i) { int R, C; stage_rc(tid * 16 + i * 8192, R, C); const int Rb = (R & ~31) + perm32(R & 31);
        voffA[i] = P.voffA(R, C, 0); voffA1[i] = TWO_A ? P.voffA(R, C, 1) : 0u; voffB[i] = P.voffB(Rb, C); }
    const unsigned ldsw = (unsigned)wid * 1024u;
    const int aoff = lds_byte(wr * 64 + fr, fq * 8), boff = lds_byte(wc * 32 + fr, fq * 8);
#define G_SA(b, h) (((b) * 2 + (h)) * HTB)
#define G_SB(b, h) ((4 + (b) * 2 + (h)) * HTB)
#define G_STAGE(bufoff, gbase, voff) do { _Pragma("unroll") for (int _i = 0; _i < 2; ++_i) \
        __builtin_amdgcn_global_load_lds((const unsigned*)((const char*)(gbase) + (voff)[_i]), (LAS unsigned*)(lds + (bufoff) + ldsw + _i * 8192), 16, 0, 0); } while (0)
#define G_STAGE_A(bufoff, u, kt, h) do { const char* _p = P.aptr(u, kt, h); const bool _c1 = TWO_A && P.acls(kt); unsigned _v[2]; _v[0] = _c1 ? voffA1[0] : voffA[0]; _v[1] = _c1 ? voffA1[1] : voffA[1]; G_STAGE(bufoff, _p, _v); } while (0)
#define G_STAGE_B(bufoff, u, kt, h) do { const char* _p = P.bptr(u, kt, h); G_STAGE(bufoff, _p, voffB); } while (0)
#define G_LDA(dst, b, h) do { _Pragma("unroll") for (int m = 0; m < 4; ++m) _Pragma("unroll") for (int k = 0; k < 2; ++k) dst[m][k] = *(const LAS h16x8*)(lds + G_SA(b, h) + aoff + m * 2048 + k * 1024); } while (0)
#define G_LDB(dst, b, h) do { _Pragma("unroll") for (int n = 0; n < 2; ++n) _Pragma("unroll") for (int k = 0; k < 2; ++k) dst[n][k] = *(const LAS h16x8*)(lds + G_SB(b, h) + boff + n * 2048 + k * 1024); } while (0)
#define G_MMA(ai, bj, At, Bt) do { __builtin_amdgcn_s_setprio(1); _Pragma("unroll") for (int m = 0; m < 4; ++m) _Pragma("unroll") for (int n = 0; n < 2; ++n) _Pragma("unroll") for (int k = 0; k < 2; ++k) \
        acc[ai][bj][m][n] = __builtin_amdgcn_mfma_f32_16x16x32_f16(Bt[n][k], At[m][k], acc[ai][bj][m][n], 0, 0, 0); __builtin_amdgcn_s_setprio(0); } while (0)
#define G_WAIT_V(n) asm volatile("s_waitcnt vmcnt(" #n ")" ::: "memory")
#define G_WAIT_L(n) asm volatile("s_waitcnt lgkmcnt(" #n ")" ::: "memory")
#define G_BAR __builtin_amdgcn_s_barrier()
#define G_SCHED __builtin_amdgcn_sched_barrier(0)
    Unit cur, nxt; int ui = 0;
    if (!P.next(0, cur)) return;
    f32x4 acc[2][2][4][2];
#pragma unroll
    for (int a = 0; a < 2; ++a)
#pragma unroll
        for (int b = 0; b < 2; ++b)
#pragma unroll
            for (int m = 0; m < 4; ++m)
#pragma unroll
                for (int n = 0; n < 2; ++n) acc[a][b][m][n] = (f32x4){0.f, 0.f, 0.f, 0.f};
    h16x8 At[4][2], B0[2][2], B1[2][2];
    G_STAGE_B(G_SB(0, 0), cur, 0, 0); G_STAGE_B(G_SB(0, 1), cur, 0, 1); G_STAGE_A(G_SA(0, 0), cur, 0, 0); G_STAGE_A(G_SA(0, 1), cur, 0, 1);
    if (wr == 1) G_BAR;
    G_WAIT_V(2); G_BAR;
    G_STAGE_B(G_SB(1, 0), cur, 1, 0); G_STAGE_A(G_SA(1, 0), cur, 1, 0); G_STAGE_B(G_SB(1, 1), cur, 1, 1);
    G_WAIT_V(6); G_BAR;
    for (;;) {
        const bool has_next = P.next(ui + 1, nxt);
        Unit nu; nu.pm = has_next ? nxt.pm : cur.pm; nu.pn = has_next ? nxt.pn : cur.pn; nu.g = has_next ? nxt.g : cur.g;
        for (int t = 0; t < nt; t += 2) {
            const bool last = (t == nt - 2);
            Unit u2; u2.pm = last ? nu.pm : cur.pm; u2.pn = last ? nu.pn : cur.pn; u2.g = last ? nu.g : cur.g;
            const int k2 = last ? 0 : t + 2, k3 = k2 + 1;
            G_LDB(B0, 0, 0); G_LDB(B1, 0, 1); G_SCHED; G_LDA(At, 0, 0); G_STAGE_A(G_SA(1, 1), cur, t + 1, 1);
            G_WAIT_V(8); G_WAIT_L(0); G_BAR; G_MMA(0, 0, At, B0); G_MMA(0, 1, At, B1); G_BAR; G_SCHED;
            G_LDA(At, 0, 1); G_STAGE_B(G_SB(0, 0), u2, k2, 0); G_STAGE_B(G_SB(0, 1), u2, k2, 1); G_STAGE_A(G_SA(0, 0), u2, k2, 0);
            G_WAIT_V(8); G_WAIT_L(0); G_BAR; G_MMA(1, 0, At, B0); G_MMA(1, 1, At, B1); G_BAR; G_SCHED;
            G_LDB(B0, 1, 0); G_LDB(B1, 1, 1); G_SCHED; G_LDA(At, 1, 0); G_STAGE_A(G_SA(0, 1), u2, k2, 1);
            G_WAIT_V(8); G_WAIT_L(0); G_BAR; G_MMA(0, 0, At, B0); G_MMA(0, 1, At, B1); G_BAR; G_SCHED;
            G_LDA(At, 1, 1); G_STAGE_B(G_SB(1, 0), u2, k3, 0); G_STAGE_B(G_SB(1, 1), u2, k3, 1); G_STAGE_A(G_SA(1, 0), u2, k3, 0);
            G_WAIT_V(8); G_WAIT_L(0); G_BAR; G_MMA(1, 0, At, B0); G_MMA(1, 1, At, B1); G_BAR; G_SCHED;
        }
        if (wr == 0) G_BAR;
        E(acc, cur, wr, wc, fr, fq, lds);
        if (!has_next) break;
#pragma unroll
        for (int a = 0; a < 2; ++a)
#pragma unroll
            for (int b = 0; b < 2; ++b)
#pragma unroll
                for (int m = 0; m < 4; ++m)
#pragma unroll
                    for (int n = 0; n < 2; ++n) acc[a][b][m][n] = (f32x4){0.f, 0.f, 0.f, 0.f};
        cur = nxt; ++ui;
        if (wr == 1) G_BAR;
    }
    G_WAIT_V(0);
    G_BAR;
#undef G_SA
#undef G_SB
#undef G_STAGE
#undef G_STAGE_A
#undef G_STAGE_B
#undef G_LDA
#undef G_LDB
#undef G_MMA
#undef G_WAIT_V
#undef G_WAIT_L
#undef G_BAR
#undef G_SCHED
}

typedef f32x4 (&AccRef)[2][2][4][2];
struct EpiWin {
    h16* GG; h16* XP;
    __device__ __forceinline__ void operator()(AccRef acc, const Unit& u, int wr, int wc, int fr, int fq, LAS unsigned char*) const {
        const int row0 = u.pm * BM + wr * 64 + fr, colb = u.pn * BM + wc * 32 + 8 * fq;
        const bool isg = u.pn < 4;
        h16* base = isg ? GG : XP - 1024;
#pragma unroll
        for (int ai = 0; ai < 2; ++ai)
#pragma unroll
            for (int m = 0; m < 4; ++m) { h16* rowp = base + (size_t)(row0 + ai * HALF + m * 16) * D + colb;
#pragma unroll
                for (int bj = 0; bj < 2; ++bj) { f32x4 v0 = acc[ai][bj][m][0], v1 = acc[ai][bj][m][1];
                    if (isg) {
#pragma unroll
                        for (int j = 0; j < 4; ++j) { v0[j] = fgelu(v0[j]); v1[j] = fgelu(v1[j]); } }
                    u32x4 w; w.x = pkh(v0[0], v0[1]); w.y = pkh(v0[2], v0[3]); w.z = pkh(v1[0], v1[1]); w.w = pkh(v1[2], v1[3]);
                    *(u32x4*)(rowp + bj * HALF) = w; } }
    }
};
template <int MODE> struct EpiRes {
    const float* xp; const float* xs;
    float* X; h16* HA; float* SS; const float* GT; const float* G2;
    __device__ __forceinline__ void operator()(AccRef acc, const Unit& u, int wr, int wc, int fr, int fq, LAS unsigned char*) const {
        const int mrr = mod_row(u.pm);
        const int row0 = u.pm * BM + wr * 64 + fr, colb = u.pn * BM + wc * 32 + 8 * fq;
        f32x4 gt[2][2], g2[2][2];
#pragma unroll
        for (int bj = 0; bj < 2; ++bj)
#pragma unroll
            for (int n = 0; n < 2; ++n) { gt[bj][n] = *(const f32x4*)(GT + (size_t)mrr * NMOD + colb + bj * HALF + 4 * n);
                g2[bj][n] = MODE == 0 ? *(const f32x4*)(G2 + (size_t)mrr * D + colb + bj * HALF + 4 * n) : (f32x4){0.f, 0.f, 0.f, 0.f}; }
#pragma unroll
        for (int ai = 0; ai < 2; ++ai)
#pragma unroll
            for (int m = 0; m < 4; ++m) { const int row = row0 + ai * HALF + m * 16;
                const float* xin = MODE == 0 ? ((u.pm < 16) ? xp + (size_t)row * D : xs + (size_t)(row - MP) * D) : X + (size_t)row * D;
                float s = 0.f;
#pragma unroll
                for (int bj = 0; bj < 2; ++bj) { f32x4 o[2];
#pragma unroll
                    for (int n = 0; n < 2; ++n) { const f32x4 xv = *(const f32x4*)(xin + colb + bj * HALF + 4 * n); o[n] = xv + gt[bj][n] * acc[ai][bj][m][n];
                        *(f32x4*)(X + (size_t)row * D + colb + bj * HALF + 4 * n) = o[n];
                        s += (o[n][0] * o[n][0] + o[n][1] * o[n][1]) + (o[n][2] * o[n][2] + o[n][3] * o[n][3]); }
                    if (MODE == 0) { const f32x4 a0 = o[0] * g2[bj][0], a1 = o[1] * g2[bj][1];
                        u32x4 w; w.x = pkh(a0[0], a0[1]); w.y = pkh(a0[2], a0[3]); w.z = pkh(a1[0], a1[1]); w.w = pkh(a1[2], a1[3]);
                        *(u32x4*)(HA + (size_t)row * D + colb + bj * HALF) = w; } }
                s += __shfl_xor(s, 16); s += __shfl_xor(s, 32);
                if (fq == 0) atomicAdd(SS + row, s); }
    }
};
struct EpiGlu {
    float* X; h16* HA; float* SS; const float* GT; const float* G2;
    __device__ __forceinline__ void operator()(AccRef acc, const Unit& u, int wr, int wc, int fr, int fq, LAS unsigned char*) const {
        const int mrr = mod_row(u.pm);
        const int row0 = u.pm * BM + wr * 64 + fr, oc = u.pn * HALF + wc * 32 + 8 * fq;
        f32x4 gt[2], g2[2];
#pragma unroll
        for (int n = 0; n < 2; ++n) { gt[n] = *(const f32x4*)(GT + (size_t)mrr * NMOD + oc + 4 * n); g2[n] = *(const f32x4*)(G2 + (size_t)mrr * D + oc + 4 * n); }
#pragma unroll
        for (int ai = 0; ai < 2; ++ai)
#pragma unroll
            for (int m = 0; m < 4; ++m) { const int row = row0 + ai * HALF + m * 16; float* xr = X + (size_t)row * D + oc; float s = 0.f; f32x4 o[2];
#pragma unroll
                for (int n = 0; n < 2; ++n) { const f32x4 xv = *(const f32x4*)(xr + 4 * n); const f32x4 v = acc[ai][0][m][n], g = acc[ai][1][m][n]; f32x4 r;
#pragma unroll
                    for (int j = 0; j < 4; ++j) r[j] = v[j] * fsigmoid(g[j]);
                    o[n] = xv + gt[n] * r; *(f32x4*)(xr + 4 * n) = o[n];
                    s += (o[n][0] * o[n][0] + o[n][1] * o[n][1]) + (o[n][2] * o[n][2] + o[n][3] * o[n][3]); }
                const f32x4 a0 = o[0] * g2[0], a1 = o[1] * g2[1];
                u32x4 w; w.x = pkh(a0[0], a0[1]); w.y = pkh(a0[2], a0[3]); w.z = pkh(a1[0], a1[1]); w.w = pkh(a1[2], a1[3]);
                *(u32x4*)(HA + (size_t)row * D + oc) = w;
                s += __shfl_xor(s, 16); s += __shfl_xor(s, 32);
                if (fq == 0) atomicAdd(SS + row, s); }
    }
};
struct EpiUp {
    const float* SS; const float* SHW; const float* CWP; const float* CBP; h16* ACT;
    __device__ __forceinline__ void operator()(AccRef acc, const Unit& u, int wr, int wc, int fr, int fq, LAS unsigned char* lds) const {
        const int mrr = mod_row(u.pm); const bool prompt = u.pm < 16;
        const int row0 = u.pm * BM + wr * 64 + fr, colt = wc * 32 + 8 * fq, colb = u.pn * BM + colt;
#pragma unroll
        for (int ai = 0; ai < 2; ++ai)
#pragma unroll
            for (int m = 0; m < 4; ++m) { const float rs = __builtin_amdgcn_rsqf(SS[row0 + ai * HALF + m * 16] * (1.0f / D) + EPS);
#pragma unroll
                for (int bj = 0; bj < 2; ++bj)
#pragma unroll
                    for (int n = 0; n < 2; ++n) acc[ai][bj][m][n] = acc[ai][bj][m][n] * rs; }
#pragma unroll
        for (int bj = 0; bj < 2; ++bj)
#pragma unroll
            for (int n = 0; n < 2; ++n) { const f32x4 sh = *(const f32x4*)(SHW + (size_t)mrr * NUP + colb + bj * HALF + 4 * n);
#pragma unroll
                for (int ai = 0; ai < 2; ++ai)
#pragma unroll
                    for (int m = 0; m < 4; ++m) acc[ai][bj][m][n] = acc[ai][bj][m][n] + sh; }
        LAS float* EX = (LAS float*)(lds + EX_OFF);
        if (prompt) {
#pragma unroll
            for (int ai = 0; ai < 2; ++ai)
#pragma unroll
                for (int bj = 0; bj < 2; ++bj)
#pragma unroll
                    for (int n = 0; n < 2; ++n) { const int q4 = 2 * ai + wr, ct = bj * HALF + colt + 4 * n;
                        if (fr == 0) *(LAS f32x4*)(EX + (q4 * 2 + 0) * 256 + ct) = acc[ai][bj][0][n];
                        if (fr == 15) *(LAS f32x4*)(EX + (q4 * 2 + 1) * 256 + ct) = acc[ai][bj][3][n]; }
            asm volatile("s_waitcnt lgkmcnt(0)" ::: "memory"); __builtin_amdgcn_s_barrier(); asm volatile("" ::: "memory");
        }
#pragma unroll
        for (int n = 0; n < 2; ++n) {
            f32x4 cw[2][3], cb[2];
#pragma unroll
            for (int bj = 0; bj < 2; ++bj) { cb[bj] = *(const f32x4*)(CBP + colb + bj * HALF + 4 * n);
#pragma unroll
                for (int k = 0; k < 3; ++k) cw[bj][k] = *(const f32x4*)(CWP + (size_t)k * NUP + colb + bj * HALF + 4 * n); }
            asm volatile("" ::: "memory");
#pragma unroll
            for (int ai = 0; ai < 2; ++ai) { const int q4 = 2 * ai + wr;
#pragma unroll
                for (int m = 0; m < 4; ++m) { f32x4 o[2];
#pragma unroll
                    for (int bj = 0; bj < 2; ++bj) { const f32x4 cur = acc[ai][bj][m][n]; f32x4 pv, nv; const int ct = bj * HALF + colt + 4 * n;
                        f32x4 pb = (f32x4){0.f, 0.f, 0.f, 0.f}, nb = (f32x4){0.f, 0.f, 0.f, 0.f};
                        if (m == 0) { if (prompt && q4 > 0) pb = *(const LAS f32x4*)(EX + ((q4 - 1) * 2 + 1) * 256 + ct); } else pb = acc[ai][bj][m == 0 ? 0 : m - 1][n];
                        if (m == 3) { if (prompt && q4 < 3) nb = *(const LAS f32x4*)(EX + ((q4 + 1) * 2 + 0) * 256 + ct); } else nb = acc[ai][bj][m == 3 ? 3 : m + 1][n];
#pragma unroll
                        for (int j = 0; j < 4; ++j) {
                            const float pin = dppf<0x121>(cur[j]);
                            const float pout = (m == 0) ? pb[j] : dppf<0x121>(pb[j]);
                            const float nin = dppf<0x12F>(cur[j]);
                            const float nout = (m == 3) ? nb[j] : dppf<0x12F>(nb[j]);
                            pv[j] = (fr == 0) ? pout : pin; nv[j] = (fr == 15) ? nout : nin; }
                        o[bj] = cb[bj] + cw[bj][0] * pv + cw[bj][1] * cur + cw[bj][2] * nv; }
                    f32x4 a;
#pragma unroll
                    for (int j = 0; j < 4; ++j) { const float g = o[1][j]; a[j] = o[0][j] * g * fsigmoid(g); }
                    u32x2 w; w.x = pkh(a[0], a[1]); w.y = pkh(a[2], a[3]);
                    *(u32x2*)(ACT + (size_t)(row0 + ai * HALF + m * 16) * DFF + u.pn * HALF + colt + 4 * n) = w;
                    asm volatile("" ::: "memory"); } } }
    }
};
struct EpiS5a {
    float* S;
    __device__ __forceinline__ void operator()(AccRef acc, const Unit& u, int wr, int wc, int fr, int fq, LAS unsigned char*) const {
        const int row0 = u.pm * BM + wr * 64 + fr, colb = wc * 32 + 8 * fq;
#pragma unroll
        for (int ai = 0; ai < 2; ++ai)
#pragma unroll
            for (int m = 0; m < 4; ++m) { float* rowp = S + ((size_t)u.g * NCHK + row0 + ai * HALF + m * 16) * 256 + colb;
#pragma unroll
                for (int bj = 0; bj < 2; ++bj)
#pragma unroll
                    for (int n = 0; n < 2; ++n) *(f32x4*)(rowp + bj * HALF + 4 * n) = acc[ai][bj][m][n] * (1.0f / 256.0f); }
    }
};
struct EpiS5c {
    h16* Z;
    __device__ __forceinline__ void operator()(AccRef acc, const Unit& u, int wr, int wc, int fr, int fq, LAS unsigned char*) const {
        const int row0 = u.pm * BM + wr * 64 + fr;
#pragma unroll
        for (int ai = 0; ai < 2; ++ai)
#pragma unroll
            for (int m = 0; m < 4; ++m) { const int j = row0 + ai * HALF + m * 16;
#pragma unroll
                for (int bj = 0; bj < 2; ++bj) { const int n0 = bj * HALF + wc * 32 + 8 * fq, t = n0 >> 4, c0 = n0 & 15;
                    f32x4 v0 = acc[ai][bj][m][0] * (1.0f / 256.0f), v1 = acc[ai][bj][m][1] * (1.0f / 256.0f);
#pragma unroll
                    for (int jj = 0; jj < 4; ++jj) { v0[jj] = fgelu(v0[jj]); v1[jj] = fgelu(v1[jj]); }
                    u32x4 w; w.x = pkh(v0[0], v0[1]); w.y = pkh(v0[2], v0[3]); w.z = pkh(v1[0], v1[1]); w.w = pkh(v1[2], v1[3]);
                    *(u32x4*)(Z + ((size_t)j * 16 + t) * D + 16 * u.g + c0) = w; } }
    }
};

__device__ __forceinline__ float wave_sum(float v) {
#pragma unroll
    for (int o = 1; o < 64; o <<= 1) v += __shfl_xor(v, o);
    return v;
}
__device__ __forceinline__ int perm_col(int n, int halfN) { return ((n >> 7) & 1) * halfN + ((n >> 8) << 7) + (n & 127); }

__device__ __forceinline__ void gemv_item(const LAS float* vec, LAS float* red, const float* W, int ldw, int src0, float* out, int ldo, const float* bias) {
    const int tid = threadIdx.x, nn = tid & 63, ks = tid >> 6;
    float acc[9];
#pragma unroll
    for (int m = 0; m < 9; ++m) acc[m] = 0.f;
    const float* wp = W + (size_t)(ks * 128) * ldw + src0 + nn;
#pragma unroll 4
    for (int kk = 0; kk < 128; ++kk) { const float w = wp[(size_t)kk * ldw];
#pragma unroll
        for (int m = 0; m < 9; ++m) acc[m] += vec[m * 1024 + ks * 128 + kk] * w; }
#pragma unroll
    for (int m = 0; m < 9; ++m) red[(ks * 9 + m) * 64 + nn] = acc[m];
    __syncthreads();
    for (int o = tid; o < 576; o += 512) { const int m = o >> 6, n2 = o & 63; float s = bias ? bias[n2] : 0.f;
#pragma unroll
        for (int k2 = 0; k2 < 8; ++k2) s += red[(k2 * 9 + m) * 64 + n2];
        out[(size_t)m * ldo + n2] = s; }
    __syncthreads();
}
__device__ __forceinline__ void transpose_item(const float* W, int K, int N, h16* WT, int src_n0, int dst_n0, int k0, LAS float* scr, int lane) {
#pragma unroll 8
    for (int i = 0; i < 32; ++i) { const int kk = 2 * i + (lane >> 5); scr[kk * 33 + (lane & 31)] = W[(size_t)(k0 + kk) * N + src_n0 + (lane & 31)]; }
    asm volatile("s_waitcnt lgkmcnt(0)" ::: "memory");
    const int c = lane & 7;
#pragma unroll
    for (int j = 0; j < 4; ++j) { const int n = (lane >> 3) + 8 * j; const LAS float* s = scr + (8 * c) * 33 + n;
        u32x4 o; o.x = pkh(s[0 * 33], s[1 * 33]); o.y = pkh(s[2 * 33], s[3 * 33]); o.z = pkh(s[4 * 33], s[5 * 33]); o.w = pkh(s[6 * 33], s[7 * 33]);
        *(u32x4*)(WT + (size_t)(dst_n0 + n) * K + k0 + 8 * c) = o; }
    asm volatile("s_waitcnt lgkmcnt(0)" ::: "memory");
}
struct f2 { float x, y; };
__device__ __forceinline__ f2 cmul(f2 a, f2 b) { f2 r; r.x = a.x * b.x - a.y * b.y; r.y = a.x * b.y + a.y * b.x; return r; }

__device__ __forceinline__ void phase_prep0(const Args& a, LAS unsigned char* lds) {
    const int tid = threadIdx.x, lane = tid & 63, wave = tid >> 6, G = gridDim.x;
    unsigned char* ws = a.ws;
    const size_t gtid = (size_t)blockIdx.x * 512 + tid, GT = (size_t)G * 512;
    { float* ss = (float*)(ws + O_SS); for (size_t i = gtid; i < (size_t)4 * M; i += GT) ss[i] = 0.f; }
    {
        LAS float* sv = (LAS float*)lds; LAS float* red = sv + 9 * 1024;
        for (int i = tid; i < 9 * 1024; i += 512) { const int mrr = i >> 10, k = i & 1023; const float cv = mrr == 0 ? a.in[I_CCTX][k] : a.in[I_C][(mrr - 1) * 1024 + k]; sv[i] = cv / (1.0f + __expf(-cv)); }
        __syncthreads();
        for (int it = blockIdx.x; it < 192; it += G) { const int l = it / 96, nb = it % 96;
            gemv_item(sv, red, a.in[I_ADAW] + (size_t)l * 1024 * NMOD, NMOD, nb * 64, (float*)(ws + O_MOD) + (size_t)l * NMR * NMOD + nb * 64, NMOD, a.in[I_ADAB] + l * NMOD + nb * 64); }
        __syncthreads();
    }
    {
        LAS float* scr = (LAS float*)(lds + wave * 16384);
        const int gw = wave * G + blockIdx.x, NGW = G * 8;
        constexpr int I_1 = 16 * 64, I_2 = 16 * 32, I_3 = 16 * 64, I_4 = 16 * 176, I_5 = 44 * 32;
        constexpr int NIT = I_1 + I_2 + I_3 + 2 * I_4 + 2 * I_5;
        for (int it = gw; it < NIT; it += NGW) {
            int r = it;
            if (r < I_1) { const int kb = r / 64, nb = r % 64; transpose_item(a.in[I_WIN], 1024, 2048, (h16*)(ws + O_WIN), 32 * nb, 32 * nb, 64 * kb, scr, lane); continue; } r -= I_1;
            if (r < I_2) { const int kb = r / 32, nb = r % 32; transpose_item(a.in[I_WOUT], 1024, 1024, (h16*)(ws + O_WOUT), 32 * nb, 32 * nb, 64 * kb, scr, lane); continue; } r -= I_2;
            if (r < I_3) { const int kb = r / 64, nb = r % 64; transpose_item(a.in[I_WGLU], 1024, 2048, (h16*)(ws + O_WGLU), perm_col(32 * nb, 1024), 32 * nb, 64 * kb, scr, lane); continue; } r -= I_3;
            if (r < 2 * I_4) { const int l = r / I_4, r2 = r % I_4, kb = r2 / 176, nb = r2 % 176;
                transpose_item(a.in[I_WUP] + (size_t)l * 1024 * NUP, 1024, NUP, (h16*)(ws + O_WUP) + (size_t)l * NUP * 1024, perm_col(32 * nb, DFF), 32 * nb, 64 * kb, scr, lane); continue; } r -= 2 * I_4;
            { const int l = r / I_5, r2 = r % I_5, kb = r2 / 32, nb = r2 % 32;
                transpose_item(a.in[I_WDN] + (size_t)l * DFF * 1024, DFF, 1024, (h16*)(ws + O_WDN) + (size_t)l * 1024 * DFF, 32 * nb, 32 * nb, 64 * kb, scr, lane); }
        }
    }
    for (size_t idx = gtid; idx < 32768; idx += GT) {
        const int ln = (int)idx & 63, ks = ((int)idx >> 6) & 3, which = ((int)idx >> 8) & 1, hf = ((int)idx >> 9) & 1, hd = ((int)idx >> 10) & 15, d = (int)idx >> 14;
        const float* src = (which ? a.in[I_WI] : a.in[I_WA]) + (size_t)((d * 16 + hd) * 64) * 64;
        const int k0 = 16 * ks + 8 * (ln >> 5), col = 32 * hf + (ln & 31);
        u32x4 o; o.x = pkh(src[(k0 + 0) * 64 + col], src[(k0 + 1) * 64 + col]); o.y = pkh(src[(k0 + 2) * 64 + col], src[(k0 + 3) * 64 + col]);
        o.z = pkh(src[(k0 + 4) * 64 + col], src[(k0 + 5) * 64 + col]); o.w = pkh(src[(k0 + 6) * 64 + col], src[(k0 + 7) * 64 + col]);
        *(u32x4*)(ws + O_GF + idx * 16) = o;
    }
    for (size_t idx = gtid; idx < 8192; idx += GT) {
        const int p = (int)idx & 63, g = ((int)idx >> 6) & 63, d = (int)idx >> 12;
        const float are = a.in[I_ARE][(d * 64 + g) * 64 + p], aim = a.in[I_AIM][(d * 64 + g) * 64 + p], dt = expf(a.in[I_LDT][d * 64 + g]);
        f2* pw = (f2*)(ws + O_PW) + ((size_t)(d * 64 + g) * 17) * 64 + p;
        for (int k = 0; k <= 16; ++k) { const float er = expf(are * dt * (float)k); const float sn = sinf(aim * dt * (float)k), cs = cosf(aim * dt * (float)k); f2 v; v.x = er * cs; v.y = er * sn; pw[(size_t)k * 64] = v; }
        const float x = are * dt, y = aim * dt; const float sn = sinf(y), cs = cosf(y), sh = sinf(0.5f * y);
        f2 num; num.x = expm1f(x) * cs - 2.0f * sh * sh; num.y = expf(x) * sn;
        const float inv = 1.0f / (are * are + aim * aim); f2 cl; cl.x = are * inv; cl.y = -aim * inv;
        const f2 f = cmul(num, cl);
        const float* bre = a.in[I_BRE] + ((size_t)(d * 64 + g) * 64 + p) * 16; const float* bim = a.in[I_BIM] + ((size_t)(d * 64 + g) * 64 + p) * 16;
        f2* bb = (f2*)(ws + O_BBAR) + ((size_t)(d * 64 + g) * 64 + p) * 16;
        for (int c = 0; c < 16; ++c) { f2 b; b.x = bre[c]; b.y = bim[c]; bb[c] = cmul(b, f); }
    }
    for (size_t idx = gtid; idx < (size_t)2 * 3 * NUP; idx += GT) { const int n = (int)(idx % NUP); const size_t lk = idx / NUP; ((float*)(ws + O_CWP))[idx] = a.in[I_FCW][lk * NUP + perm_col(n, DFF)]; }
    for (size_t idx = gtid; idx < (size_t)2 * NUP; idx += GT) { const int n = (int)(idx % NUP); const size_t l = idx / NUP; ((float*)(ws + O_CBP))[idx] = a.in[I_FCB][l * NUP + perm_col(n, DFF)]; }
}

__device__ __forceinline__ void modulate_row(const float* xrow, const float* g1, const float* sh, h16* orow, int lane, float rs_in, bool have_rs) {
    const f32x4* xr = (const f32x4*)xrow + lane;
    f32x4 v[4]; float s = 0.f;
#pragma unroll
    for (int j = 0; j < 4; ++j) { v[j] = xr[64 * j]; s += (v[j][0] * v[j][0] + v[j][1] * v[j][1]) + (v[j][2] * v[j][2] + v[j][3] * v[j][3]); }
    float rs = rs_in;
    if (!have_rs) rs = 1.0f / sqrtf(wave_sum(s) * (1.0f / D) + EPS);
#pragma unroll
    for (int j = 0; j < 4; ++j) { const f32x4 gg = *((const f32x4*)g1 + lane + 64 * j), ss = *((const f32x4*)sh + lane + 64 * j); const f32x4 o = v[j] * rs * gg + ss;
        u32x2 w; w.x = pkh(o[0], o[1]); w.y = pkh(o[2], o[3]); *((u32x2*)orow + lane + 64 * j) = w; }
}

__device__ __forceinline__ void phase_prep1(const Args& a, LAS unsigned char* lds) {
    const int tid = threadIdx.x, lane = tid & 63, wave = tid >> 6, G = gridDim.x;
    unsigned char* ws = a.ws;
    const size_t gtid = (size_t)blockIdx.x * 512 + tid, GT = (size_t)G * 512;
    const float* MOD = (const float*)(ws + O_MOD);
    {
        LAS float* sv = (LAS float*)lds; LAS float* red = sv + 9 * 1024;
        for (int it = blockIdx.x; it < 176; it += G) { const int l = it / 88, nb = it % 88;
            __syncthreads();
            for (int i = tid; i < 9 * 1024; i += 512) sv[i] = MOD[(size_t)(l * NMR + (i >> 10)) * NMOD + 3072 + (i & 1023)];
            __syncthreads();
            gemv_item(sv, red, a.in[I_WUP] + (size_t)l * 1024 * NUP, NUP, perm_col(nb * 64, DFF), (float*)(ws + O_SHW) + (size_t)l * NMR * NUP + nb * 64, NUP, nullptr); }
        __syncthreads();
    }
    for (size_t idx = gtid; idx < (size_t)2 * NMR * D; idx += GT) { const int c = (int)idx & 1023; const int lm = (int)(idx >> 10), l = lm / NMR;
        ((float*)(ws + O_G1T))[idx] = a.in[I_NMIX][l * D + c] * (1.0f + MOD[(size_t)lm * NMOD + 1024 + c]);
        ((float*)(ws + O_G2T))[idx] = a.in[I_NFFN][l * D + c] * (1.0f + MOD[(size_t)lm * NMOD + 4096 + c]); }
    {
        const int gw = wave * G + blockIdx.x, NGW = G * 8;
        for (int r = gw; r < M; r += NGW) { const int mrr = r < MP ? 0 : 1 + ((r - MP) >> 12);
            const float* xrow = r < MP ? a.in[I_XP] + (size_t)r * D : a.in[I_XS] + (size_t)(r - MP) * D;
            const float* sc = MOD + (size_t)mrr * NMOD + 1024; const float* sh = MOD + (size_t)mrr * NMOD;
            const f32x4* xr = (const f32x4*)xrow + lane; f32x4 v[4]; float s = 0.f;
#pragma unroll
            for (int j = 0; j < 4; ++j) { v[j] = xr[64 * j]; s += (v[j][0] * v[j][0] + v[j][1] * v[j][1]) + (v[j][2] * v[j][2] + v[j][3] * v[j][3]); }
            const float rs = 1.0f / sqrtf(wave_sum(s) * (1.0f / D) + EPS);
#pragma unroll
            for (int j = 0; j < 4; ++j) { const f32x4 nm = *((const f32x4*)a.in[I_NMIX] + lane + 64 * j), scv = *((const f32x4*)sc + lane + 64 * j), shv = *((const f32x4*)sh + lane + 64 * j);
                const f32x4 o = v[j] * rs * nm * (scv + 1.0f) + shv;
                u32x2 w; w.x = pkh(o[0], o[1]); w.y = pkh(o[2], o[3]); *((u32x2*)((h16*)(ws + O_HA) + (size_t)r * D) + lane + 64 * j) = w; }
        }
    }
    const f2* PW = (const f2*)(ws + O_PW); const f2* BB = (const f2*)(ws + O_BBAR);
    for (size_t idx = gtid; idx < (size_t)64 * 2 * 16 * 256; idx += GT) {
        const int ci = (int)idx & 15, co = ((int)idx >> 4) & 15, tau = ((int)idx >> 8) & 15, d = ((int)idx >> 12) & 1, g = (int)(idx >> 13);
        const float* cre = a.in[I_CRE] + ((size_t)(d * 64 + g) * 16 + co) * 64; const float* cim = a.in[I_CIM] + ((size_t)(d * 64 + g) * 16 + co) * 64;
        const f2* pw = PW + ((size_t)(d * 64 + g) * 17 + tau) * 64; const f2* bb = BB + ((size_t)(d * 64 + g) * 64) * 16 + ci;
        float s = 0.f;
        for (int p = 0; p < 64; ++p) { f2 c; c.x = cre[p]; c.y = cim[p]; const f2 t = cmul(c, pw[p]); const f2 b = bb[(size_t)p * 16]; s += t.x * b.x - t.y * b.y; }
        ((float*)(ws + O_KT))[idx] = s;
    }
    for (size_t idx = gtid; idx < (size_t)64 * 256 * 16; idx += GT) {
        const int s = (int)idx & 15, n = ((int)idx >> 4) & 255, g = (int)(idx >> 12), d = n >> 7, part = (n >> 6) & 1, p = n & 63;
        const f2 av = PW[((size_t)(d * 64 + g) * 17 + (d ? s : 15 - s)) * 64 + p]; const f2* bb = BB + ((size_t)(d * 64 + g) * 64 + p) * 16;
        float v[16];
#pragma unroll
        for (int c = 0; c < 16; ++c) { const f2 t = cmul(av, bb[c]); v[c] = 256.0f * (part ? t.y : t.x); }
        u32x4 o0, o1; o0.x = pkh(v[0], v[1]); o0.y = pkh(v[2], v[3]); o0.z = pkh(v[4], v[5]); o0.w = pkh(v[6], v[7]); o1.x = pkh(v[8], v[9]); o1.y = pkh(v[10], v[11]); o1.z = pkh(v[12], v[13]); o1.w = pkh(v[14], v[15]);
        u32x4* dst = (u32x4*)((h16*)(ws + O_WS) + ((size_t)(g * 256 + n) * 256 + s * 16)); dst[0] = o0; dst[1] = o1;
    }
    for (size_t idx = gtid; idx < (size_t)64 * 256 * 32; idx += GT) {
        const int oct = (int)idx & 31, n = ((int)idx >> 5) & 255, g = (int)(idx >> 13), t = n >> 4, co = n & 15, kk0 = oct * 8, d = kk0 >> 7, part = (kk0 >> 6) & 1, p0 = kk0 & 63;
        const float* cre = a.in[I_CRE] + ((size_t)(d * 64 + g) * 16 + co) * 64 + p0; const float* cim = a.in[I_CIM] + ((size_t)(d * 64 + g) * 16 + co) * 64 + p0;
        const f2* pw = PW + ((size_t)(d * 64 + g) * 17 + (d ? 16 - t : t + 1)) * 64 + p0;
        float v[8];
#pragma unroll
        for (int e = 0; e < 8; ++e) { f2 c; c.x = cre[e]; c.y = cim[e]; const f2 tt = cmul(c, pw[e]); v[e] = 256.0f * (part ? -tt.y : tt.x); }
        u32x4 o; o.x = pkh(v[0], v[1]); o.y = pkh(v[2], v[3]); o.z = pkh(v[4], v[5]); o.w = pkh(v[6], v[7]);
        *(u32x4*)((h16*)(ws + O_WY) + ((size_t)(g * 256 + n) * 512 + 256 + kk0)) = o;
    }
}
__device__ __forceinline__ void build_wy_m(const Args& a) {
    unsigned char* ws = a.ws; const size_t gtid = (size_t)blockIdx.x * 512 + threadIdx.x, GT = (size_t)gridDim.x * 512;
    const float* KT = (const float*)(ws + O_KT);
    for (size_t idx = gtid; idx < (size_t)64 * 256 * 32; idx += GT) {
        const int oct = (int)idx & 31, n = ((int)idx >> 5) & 255, g = (int)(idx >> 13), t = n >> 4, co = n & 15, k0 = oct * 8, s = k0 >> 4, ci0 = k0 & 15;
        float v[8];
#pragma unroll
        for (int e = 0; e < 8; ++e) { const int ci = ci0 + e; float x = 0.f;
            if (t >= s) x += KT[((((size_t)g * 2 + 0) * 16 + (t - s)) * 16 + co) * 16 + ci];
            if (s >= t) x += KT[((((size_t)g * 2 + 1) * 16 + (s - t)) * 16 + co) * 16 + ci];
            if (t == s && co == ci) x += a.in[I_S5D][16 * g + co];
            v[e] = 256.0f * x; }
        u32x4 o; o.x = pkh(v[0], v[1]); o.y = pkh(v[2], v[3]); o.z = pkh(v[4], v[5]); o.w = pkh(v[6], v[7]);
        *(u32x4*)((h16*)(ws + O_WY) + ((size_t)(g * 256 + n) * 512 + k0)) = o;
    }
}
__device__ __forceinline__ void phase_mod1(const Args& a) {
    const int lane = threadIdx.x & 63, wave = threadIdx.x >> 6, G = gridDim.x; unsigned char* ws = a.ws;
    const float* SS1 = (const float*)(ws + O_SS) + (size_t)1 * M; const float* MOD1 = (const float*)(ws + O_MOD) + (size_t)NMR * NMOD; const float* G1 = (const float*)(ws + O_G1T) + (size_t)NMR * D;
    for (int r = wave * G + blockIdx.x; r < M; r += G * 8) { const int mrr = r < MP ? 0 : 1 + ((r - MP) >> 12);
        const float rs = 1.0f / sqrtf(SS1[r] * (1.0f / D) + EPS);
        modulate_row(a.out + (size_t)r * D, G1 + (size_t)mrr * D, MOD1 + (size_t)mrr * NMOD, (h16*)(ws + O_HA) + (size_t)r * D, lane, rs, true); }
}
__device__ __forceinline__ void phase_final(const Args& a) {
    const int lane = threadIdx.x & 63, wave = threadIdx.x >> 6, G = gridDim.x; unsigned char* ws = a.ws;
    const float* SS3 = (const float*)(ws + O_SS) + (size_t)3 * M;
    for (int r = wave * G + blockIdx.x; r < M; r += G * 8) { const float rs = 1.0f / sqrtf(SS3[r] * (1.0f / D) + EPS);
        f32x4* xr = (f32x4*)(a.out + (size_t)r * D) + lane;
#pragma unroll
        for (int j = 0; j < 4; ++j) { const f32x4 nf = *((const f32x4*)a.in[I_NFIN] + lane + 64 * j); xr[64 * j] = xr[64 * j] * rs * nf; } }
}
__device__ __forceinline__ void phase_s5scan(const Args& a) {
    const int lane = threadIdx.x & 63, wave = threadIdx.x >> 6, G = gridDim.x; unsigned char* ws = a.ws;
    const float* S = (const float*)(ws + O_S); h16* Hh = (h16*)(ws + O_H); const f2* PW = (const f2*)(ws + O_PW);
    for (int wi = wave * G + blockIdx.x; wi < 3072; wi += G * 8) {
        int q, g, d, nchk, j0;
        if (wi < 1024) { q = 16 + (wi >> 7); g = (wi & 127) >> 1; d = wi & 1; nchk = 256; j0 = 256 + 256 * (q - 16); }
        else { const int w2 = wi - 1024; q = w2 >> 7; g = (w2 & 127) >> 1; d = w2 & 1; nchk = 16; j0 = 16 * q; }
        const f2 aT = PW[((size_t)(d * 64 + g) * 17 + 16) * 64 + lane];
        float hr = 0.f, hi = 0.f;
        if (q >= 16) { const size_t o = ((size_t)((q - 16) * 2 + d) * 64 + g) * 64 + lane; hr = a.in[I_S5RE][o]; hi = a.in[I_S5IM][o]; }
        const size_t base = ((size_t)g * NCHK) * 256 + d * 128 + lane;
        const size_t hbase = (size_t)(8 * d + (lane >> 4)) * 1024 + 16 * g + (lane & 15);
        const int step = d ? -1 : 1; int j = d ? j0 + nchk - 1 : j0;
#pragma unroll 8
        for (int k = 0; k < nchk; ++k, j += step) {
            const float sr = S[base + (size_t)j * 256], si = S[base + (size_t)j * 256 + 64];
            Hh[hbase + (size_t)j * 16384] = (h16)hr; Hh[hbase + (size_t)j * 16384 + 4096] = (h16)hi;
            const float nr = aT.x * hr - aT.y * hi + sr, ni = aT.x * hi + aT.y * hr + si; hr = nr; hi = ni;
        }
        if (q < 16) { const size_t o = ((size_t)(q * 2 + d) * 64 + g) * 64 + lane; a.out[OUT_S5RE + o] = hr; a.out[OUT_S5IM + o] = hi; }
    }
}

template <int BW>
__device__ __forceinline__ void lru_scan_core(const float (&A)[16], const float (&B)[16], float (&hf)[16], float& hc, int hh, int w4, LAS float* CARd, int c32) {
    float hl[16], cp[16], rA[4], rB[4];
#pragma unroll
    for (int g = 0; g < 4; ++g) { float h = 0.f, p = 1.f;
#pragma unroll
        for (int jj = 0; jj < 4; ++jj) { const int i = 4 * g + (BW ? 3 - jj : jj); h = A[i] * h + B[i]; p *= A[i]; hl[i] = h; cp[i] = p; }
        rA[g] = p; rB[g] = h; }
    float Alo[4], Blo[4], Ahi[4], Bhi[4];
#pragma unroll
    for (int g = 0; g < 4; ++g) { const float oA = __shfl_xor(rA[g], 32), oB = __shfl_xor(rB[g], 32);
        Alo[g] = hh ? oA : rA[g]; Blo[g] = hh ? oB : rB[g]; Ahi[g] = hh ? rA[g] : oA; Bhi[g] = hh ? rB[g] : oB; }
    float WA = 1.f, WB = 0.f;
#pragma unroll
    for (int gg = 0; gg < 4; ++gg) { const int g = BW ? 3 - gg : gg;
        if (BW) { WB = Ahi[g] * WB + Bhi[g]; WA *= Ahi[g]; WB = Alo[g] * WB + Blo[g]; WA *= Alo[g]; }
        else    { WB = Alo[g] * WB + Blo[g]; WA *= Alo[g]; WB = Ahi[g] * WB + Bhi[g]; WA *= Ahi[g]; } }
    if (hh == 0) { CARd[(w4 * 32 + c32) * 2 + 0] = WA; CARd[(w4 * 32 + c32) * 2 + 1] = WB; }
    asm volatile("s_waitcnt lgkmcnt(0)" ::: "memory");
    __syncthreads();
    float x = hc, hin = 0.f;
#pragma unroll
    for (int ww = 0; ww < 4; ++ww) { const int w = BW ? 3 - ww : ww; const float ca = CARd[(w * 32 + c32) * 2 + 0], cb = CARd[(w * 32 + c32) * 2 + 1];
        if (w == w4) hin = x;
        x = ca * x + cb; }
    hc = x;
    x = hin;
#pragma unroll
    for (int gg = 0; gg < 4; ++gg) { const int g = BW ? 3 - gg : gg; float cin;
        if (BW) { const float x0 = x, x1 = Ahi[g] * x0 + Bhi[g], x2 = Alo[g] * x1 + Blo[g]; cin = hh ? x0 : x1; x = x2; }
        else    { const float x0 = x, x1 = Alo[g] * x0 + Blo[g], x2 = Ahi[g] * x1 + Bhi[g]; cin = hh ? x1 : x0; x = x2; }
#pragma unroll
        for (int j = 0; j < 4; ++j) hf[4 * g + j] = hl[4 * g + j] + cp[4 * g + j] * cin; }
}

__device__ __forceinline__ void phase_lru(const Args& a, LAS unsigned char* lds) {
    const int tid = threadIdx.x, wave = __builtin_amdgcn_readfirstlane(tid >> 6), lane = tid & 63, G = gridDim.x;
    const int d = wave >> 2, w4 = wave & 3, dtid = tid & 255, c32 = lane & 31, hh = lane >> 5, oct = dtid & 7, run = dtid >> 3;
    unsigned char* ws = a.ws;
    LAS unsigned char* XR16 = lds + d * (128 * 144);
    LAS float* XR32 = (LAS float*)(lds + 36864) + d * (128 * 32);
    LAS float* CARd = (LAS float*)(lds + 36864 + 32768) + d * (4 * 32 * 2);
    LAS float* CWL = (LAS float*)(lds + 36864 + 32768 + 2048);
    const h16* XP = (const h16*)(ws + O_XP); const h16* GG = (const h16*)(ws + O_GG); h16* SCR = (h16*)(ws + O_SCR); h16* YG = (h16*)(ws + O_HB);
    for (int item = blockIdx.x; item < 768; item += G) {
        int q, hd, hf, L; size_t row0, scr0;
        if (item < 256) { q = 16 + (item >> 5); hd = (item & 31) >> 1; hf = item & 1; L = 4096; row0 = (size_t)MP + (size_t)(q - 16) * 4096; scr0 = (size_t)item * 4096; }
        else { const int it2 = item - 256; q = it2 >> 5; hd = (it2 & 31) >> 1; hf = it2 & 1; L = 256; row0 = (size_t)q * 256; scr0 = (size_t)256 * 4096 + (size_t)it2 * 256; }
        const int nch = L >> 7;
        const int chc = 64 * hd + 8 * oct;
        if (tid < 320) { const int k = tid >> 6, c = tid & 63; CWL[tid] = k < 4 ? a.in[I_LCW][k * 1024 + 64 * hd + c] : a.in[I_LCB][64 * hd + c]; }
        __syncthreads();
        h16x8 gfa[4], gfi[4];
#pragma unroll
        for (int ks = 0; ks < 4; ++ks) { gfa[ks] = *(const h16x8*)(ws + O_GF + ((size_t)(((((d * 16 + hd) * 2 + hf) * 2 + 0) * 4 + ks) * 64 + lane)) * 16);
            gfi[ks] = *(const h16x8*)(ws + O_GF + ((size_t)(((((d * 16 + hd) * 2 + hf) * 2 + 1) * 4 + ks) * 64 + lane)) * 16); }
        const int chD = 64 * hd + 32 * hf + c32;
        const float ba = a.in[I_BA][d * 1024 + chD], bi = a.in[I_BI][d * 1024 + chD];
        const float lam = a.in[I_LAM][d * 1024 + chD];
        const float cs = 8.0f * (lam > 15.f ? expf(-lam) : log1pf(expf(-lam)));
        float hc = (q >= 16) ? a.in[I_SLRU][((size_t)(q - 16) * 2 + d) * 1024 + chD] : 0.f;
        for (int k = 0; k < nch; ++k) {
            const int ck = d ? nch - 1 - k : k, t0 = ck * 128;
            { const int tb = t0 + 4 * run - 2; h16x8 xin[7];
                float cw[4][8], cb[8];
#pragma unroll
                for (int k = 0; k < 4; ++k) { const f32x4 w0 = *(const LAS f32x4*)(CWL + k * 64 + 8 * oct), w1 = *(const LAS f32x4*)(CWL + k * 64 + 8 * oct + 4);
                    cw[k][0] = w0[0]; cw[k][1] = w0[1]; cw[k][2] = w0[2]; cw[k][3] = w0[3]; cw[k][4] = w1[0]; cw[k][5] = w1[1]; cw[k][6] = w1[2]; cw[k][7] = w1[3]; }
                { const f32x4 w0 = *(const LAS f32x4*)(CWL + 256 + 8 * oct), w1 = *(const LAS f32x4*)(CWL + 256 + 8 * oct + 4);
                    cb[0] = w0[0]; cb[1] = w0[1]; cb[2] = w0[2]; cb[3] = w0[3]; cb[4] = w1[0]; cb[5] = w1[1]; cb[6] = w1[2]; cb[7] = w1[3]; }
#pragma unroll
                for (int i = 0; i < 7; ++i) { const int t = tb + i; const int tc = t < 0 ? 0 : (t >= L ? L - 1 : t);
                    h16x8 v = *(const h16x8*)(XP + (row0 + tc) * D + chc);
                    if (t < 0 || t >= L) v = (h16x8){0, 0, 0, 0, 0, 0, 0, 0};
                    xin[i] = v; }
#pragma unroll
                for (int o = 0; o < 4; ++o) { float r[8];
#pragma unroll
                    for (int e = 0; e < 8; ++e) r[e] = cb[e] + cw[0][e] * (float)xin[o][e] + cw[1][e] * (float)xin[o + 1][e] + cw[2][e] * (float)xin[o + 2][e] + cw[3][e] * (float)xin[o + 3][e];
                    u32x4 w; w.x = pkh(r[0], r[1]); w.y = pkh(r[2], r[3]); w.z = pkh(r[4], r[5]); w.w = pkh(r[6], r[7]);
                    *(LAS u32x4*)(XR16 + (4 * run + o) * 144 + oct * 16) = w;
                    if ((oct >> 2) == hf) { LAS f32x4* dst = (LAS f32x4*)(XR32 + (4 * run + o) * 32 + (oct & 3) * 8);
                        dst[0] = (f32x4){r[0], r[1], r[2], r[3]}; dst[1] = (f32x4){r[4], r[5], r[6], r[7]}; } } }
            asm volatile("s_waitcnt vmcnt(0) lgkmcnt(0)" ::: "memory");
            __syncthreads();
            f32x16 aR, aI;
#pragma unroll
            for (int i = 0; i < 16; ++i) { aR[i] = 0.f; aI[i] = 0.f; }
#pragma unroll
            for (int ks = 0; ks < 4; ++ks) { const h16x8 af = *(const LAS h16x8*)(XR16 + (32 * w4 + c32) * 144 + (16 * ks + 8 * hh) * 2);
                aR = __builtin_amdgcn_mfma_f32_32x32x16_f16(af, gfa[ks], aR, 0, 0, 0); aI = __builtin_amdgcn_mfma_f32_32x32x16_f16(af, gfi[ks], aI, 0, 0, 0); }
            float A[16], B[16];
#pragma unroll
            for (int i = 0; i < 16; ++i) { const int tok = (i & 3) + 8 * (i >> 2) + 4 * hh; const float xr = XR32[(32 * w4 + tok) * 32 + c32];
                const float r = fsigmoid(aR[i] + ba), ig = fsigmoid(aI[i] + bi);
                const float x = cs * r;
                const float av = __builtin_amdgcn_exp2f(-1.4426950409f * x);
                const float om = (x < 0.01f) ? 2.0f * x * (1.0f - x + 0.66666667f * x * x) : 1.0f - av * av;
                A[i] = av; B[i] = __builtin_amdgcn_sqrtf(om) * ig * xr; }
            float hfv[16];
            if (d == 0) lru_scan_core<0>(A, B, hfv, hc, hh, w4, CARd, c32); else lru_scan_core<1>(A, B, hfv, hc, hh, w4, CARd, c32);
            const size_t sb = (scr0 + t0 + 32 * w4) * 32 + c32; const size_t rb = (row0 + t0 + 32 * w4) * D + chD;
            if (2 * k < nch) {
#pragma unroll
                for (int i = 0; i < 16; ++i) { const int tok = (i & 3) + 8 * (i >> 2) + 4 * hh; SCR[sb + (size_t)tok * 32] = (h16)hfv[i]; }
            } else {
#pragma unroll
                for (int i = 0; i < 16; ++i) { const int tok = (i & 3) + 8 * (i >> 2) + 4 * hh;
                    const float y = hfv[i] + (float)SCR[sb + (size_t)tok * 32]; YG[rb + (size_t)tok * D] = (h16)(y * (float)GG[rb + (size_t)tok * D]); }
            }
        }
        if (q < 16 && w4 == 0 && hh == 0) a.out[OUT_LRU + ((size_t)q * 2 + d) * 1024 + chD] = hc;
        __syncthreads();
    }
}

__global__ void __launch_bounds__(512, 2) fwd_kernel(Args a) {
    extern __shared__ __attribute__((aligned(16))) unsigned char lds_raw[];
    LAS unsigned char* lds = (LAS unsigned char*)lds_raw;
    cg::grid_group grid = cg::this_grid();
    unsigned char* ws = a.ws; const int G = gridDim.x, bx = blockIdx.x;
    const int lo = a.ph_lo, hi = a.ph_hi;
#ifndef PH_MASK
#define PH_MASK 0x7fff
#endif
#define IN(k) (((PH_MASK >> (k)) & 1) && lo <= (k) && (k) < hi)
#define SEAM(k) do { if (IN(k) && IN((k) + 1)) grid.sync(); } while (0)
    float* X = a.out;
    const float* MOD = (const float*)(ws + O_MOD); float* SS = (float*)(ws + O_SS); const float* G2T = (const float*)(ws + O_G2T);
    h16* HA = (h16*)(ws + O_HA); h16* HB = (h16*)(ws + O_HB);
    if (IN(0)) phase_prep0(a, lds);
    SEAM(0);
    if (IN(1)) phase_prep1(a, lds);
    SEAM(1);
    if (IN(2)) { build_wy_m(a);
        ProbStd P; P.init(HA, ws + O_WIN, M, 2048, 1024, G, bx); EpiWin E{(h16*)(ws + O_GG), (h16*)(ws + O_XP)};
        gemm_phase<EpiWin, ProbStd, false>(lds, P, E); }
    SEAM(2);
    if (IN(3)) phase_lru(a, lds);
    SEAM(3);
    if (IN(4)) { ProbStd P; P.init(HB, ws + O_WOUT, M, 1024, 1024, G, bx);
        EpiRes<0> E{a.in[I_XP], a.in[I_XS], X, HA, SS, MOD + 2048, G2T};
        gemm_phase<EpiRes<0>, ProbStd, false>(lds, P, E); }
    SEAM(4);
    if (IN(5)) { ProbStd P; P.init(HA, ws + O_WUP, M, NUP, 1024, G, bx);
        EpiUp E{SS, (const float*)(ws + O_SHW), (const float*)(ws + O_CWP), (const float*)(ws + O_CBP), (h16*)(ws + O_ACT)};
        gemm_phase<EpiUp, ProbStd, false>(lds, P, E); }
    SEAM(5);
    if (IN(6)) { ProbStd P; P.init(ws + O_ACT, ws + O_WDN, M, 1024, DFF, G, bx);
        EpiRes<1> E{nullptr, nullptr, X, nullptr, SS + M, MOD + 5120, nullptr};
        gemm_phase<EpiRes<1>, ProbStd, false>(lds, P, E); }
    SEAM(6);
    if (IN(7)) phase_mod1(a);
    SEAM(7);
    if (IN(8)) { ProbS5<false> P; P.init(HA, nullptr, ws + O_WS, 256, G, bx); EpiS5a E{(float*)(ws + O_S)};
        gemm_phase<EpiS5a, ProbS5<false>, false>(lds, P, E); }
    SEAM(8);
    if (IN(9)) phase_s5scan(a);
    SEAM(9);
    if (IN(10)) { ProbS5<true> P; P.init(HA, ws + O_H, ws + O_WY, 512, G, bx); EpiS5c E{HB};
        gemm_phase<EpiS5c, ProbS5<true>, false>(lds, P, E); }
    SEAM(10);
    if (IN(11)) { ProbStd P; P.init(HB, ws + O_WGLU, M, 2048, 1024, G, bx);
        EpiGlu E{X, HA, SS + 2 * (size_t)M, MOD + (size_t)NMR * NMOD + 2048, G2T + (size_t)NMR * D};
        gemm_phase<EpiGlu, ProbStd, false>(lds, P, E); }
    SEAM(11);
    if (IN(12)) { ProbStd P; P.init(HA, ws + O_WUP + (size_t)NUP * 1024 * 2, M, NUP, 1024, G, bx);
        EpiUp E{SS + 2 * (size_t)M, (const float*)(ws + O_SHW) + (size_t)NMR * NUP, (const float*)(ws + O_CWP) + (size_t)3 * NUP, (const float*)(ws + O_CBP) + NUP, (h16*)(ws + O_ACT)};
        gemm_phase<EpiUp, ProbStd, false>(lds, P, E); }
    SEAM(12);
    if (IN(13)) { ProbStd P; P.init(ws + O_ACT, ws + O_WDN + (size_t)1024 * DFF * 2, M, 1024, DFF, G, bx);
        EpiRes<1> E{nullptr, nullptr, X, nullptr, SS + 3 * (size_t)M, MOD + (size_t)NMR * NMOD + 5120, nullptr};
        gemm_phase<EpiRes<1>, ProbStd, false>(lds, P, E); }
    SEAM(13);
    if (IN(14)) phase_final(a);
#undef IN
#undef SEAM
}

#ifndef N_LAUNCHES
#define N_LAUNCHES 1
#endif
extern "C" void kernel_launch(void* const* d_in, const int* in_sizes, int n_in, void* d_out, int out_size, void* d_ws, size_t ws_size, hipStream_t stream) {
    static int grid = 0;
    if (grid == 0) {
        if (n_in != 34 || out_size != (int)(OUT_S5IM + 131072) || ws_size < WS_END) { fprintf(stderr, "kernel_launch: unexpected shapes: n_in %d out %d ws %zu (need %zu)\n", n_in, out_size, ws_size, (size_t)WS_END); grid = -1; return; }
        int dev = 0, cus = 0, per_cu = 0;
        if (hipGetDevice(&dev) != hipSuccess || hipDeviceGetAttribute(&cus, hipDeviceAttributeMultiprocessorCount, dev) != hipSuccess) { grid = -1; return; }
        if (hipFuncSetAttribute((const void*)fwd_kernel, hipFuncAttributeMaxDynamicSharedMemorySize, LDS_BYTES) != hipSuccess) { fprintf(stderr, "kernel_launch: hipFuncSetAttribute failed\n"); grid = -1; return; }
        if (hipOccupancyMaxActiveBlocksPerMultiprocessor(&per_cu, (const void*)fwd_kernel, 512, LDS_BYTES) != hipSuccess || per_cu < 1) { fprintf(stderr, "kernel_launch: occupancy query says %d blocks per CU\n", per_cu); grid = -1; return; }
        grid = cus;
    }
    if (grid < 0) return;
    Args a{};
    for (int i = 0; i < 34; ++i) a.in[i] = (const float*)d_in[i];
    a.out = (float*)d_out; a.ws = (unsigned char*)d_ws;
    const int nl = N_LAUNCHES;
    for (int li = 0; li < nl; ++li) {
        a.ph_lo = (nl == 1) ? 0 : li; a.ph_hi = (nl == 1) ? 15 : li + 1;
        void* args[] = {&a};
        hipError_t e = hipLaunchCooperativeKernel((const void*)fwd_kernel, dim3(grid), dim3(512), args, LDS_BYTES, stream);
        if (e != hipSuccess) { fprintf(stderr, "kernel_launch: cooperative launch failed: %s (grid %d)\n", hipGetErrorString(e), grid); break; }
    }
}
```
